# Optimizing an MI355X kernel written in HIP

```python
import math
import jax, jax.numpy as jnp
from jax import lax
import numpy as np

D_MODEL = 1024
BATCH = 8
SEQ = 4096
DEPTH = 1

MEM_LEN = 256
MLA_HEADS = 8
MLA_NOPE = 64
MLA_ROPE = 32
MLA_V = 64
MLA_Q_LORA = 256
MLA_KV_LORA = 128
MLA_WIDTH = MLA_HEADS * MLA_V
SB_HEADS = 8
SB_HEAD_DIM = 64
SB_WIDTH = SB_HEADS * SB_HEAD_DIM
MEM_HEADS = 4
MEM_HEAD_DIM = 128
MEM_WIDTH = MEM_HEADS * MEM_HEAD_DIM
N_BRANCHES = 3

BLOCK_Q = 128
ROPE_BASE = 10000.0
RMS_EPS = 1e-6
LN_EPS = 1e-5
DEEPNORM_ALPHA = (2.0 * DEPTH) ** 0.25
DEEPNORM_BETA = (8.0 * DEPTH) ** -0.25

IN_SIZES = [
    MLA_Q_LORA, MLA_KV_LORA, MLA_ROPE, MLA_WIDTH,
    SB_WIDTH, SB_WIDTH, SB_WIDTH, SB_WIDTH,
    MEM_WIDTH, MEM_WIDTH,
]
IN_WIDTH = int(sum(IN_SIZES))
IN_OFFSETS = [int(o) for o in np.cumsum(IN_SIZES)[:-1]]

kernel_name = "hybrid_mla_stickbreaking_memxattn_deepnorm"


def _rms_norm(x, g):
    x32 = x.astype(jnp.float32)
    y = x32 * lax.rsqrt(jnp.mean(x32 * x32, axis=-1, keepdims=True) + RMS_EPS)
    return (y * g.astype(jnp.float32)).astype(x.dtype)


def _layer_norm(x, g, b):
    x32 = x.astype(jnp.float32)
    mu = jnp.mean(x32, axis=-1, keepdims=True)
    xc = x32 - mu
    var = jnp.mean(xc * xc, axis=-1, keepdims=True)
    y = xc * lax.rsqrt(var + LN_EPS) * g.astype(jnp.float32) + b.astype(jnp.float32)
    return y.astype(x.dtype)


def _rope(x, pos):
    half = x.shape[-1] // 2
    freqs = ROPE_BASE ** (-jnp.arange(half, dtype=jnp.float32) / half)
    ang = pos.astype(jnp.float32)[:, None] * freqs[None, :]
    cos = jnp.cos(ang)[None, :, None, :]
    sin = jnp.sin(ang)[None, :, None, :]
    x32 = x.astype(jnp.float32)
    x1, x2 = x32[..., :half], x32[..., half:]
    out = jnp.concatenate([x1 * cos - x2 * sin, x1 * sin + x2 * cos], axis=-1)
    return out.astype(x.dtype)


def _sweep_query_blocks(q, k, v, weights_fn):
    seq = q.shape[1]
    outs = []
    for start in range(0, seq, BLOCK_Q):
        end = start + BLOCK_Q
        scores = jnp.einsum('bqhd,bkhd->bhqk', q[:, start:end], k[:, :end]).astype(jnp.float32)
        q_pos = (start + jnp.arange(BLOCK_Q))[:, None]
        k_pos = jnp.arange(end)[None, :]
        w = weights_fn(scores, q_pos, k_pos)
        outs.append(jnp.einsum('bhqk,bkhd->bqhd', w.astype(v.dtype), v[:, :end]))
    return jnp.concatenate(outs, axis=1)


def _softmax_causal_weights(scale):
    def fn(scores, q_pos, k_pos):
        s = jnp.where(k_pos <= q_pos, scores * scale, jnp.finfo(jnp.float32).min)
        return jax.nn.softmax(s, axis=-1)
    return fn


def _stick_breaking_weights(scale):
    def fn(scores, q_pos, k_pos):
        z = scores * scale
        strict = k_pos < q_pos
        log_beta = jax.nn.log_sigmoid(z)
        log_keep = jnp.where(strict, jax.nn.log_sigmoid(-z), 0.0)
        after = lax.cumsum(log_keep, axis=log_keep.ndim - 1, reverse=True) - log_keep
        return jnp.where(strict, jnp.exp(log_beta + after), 0.0)
    return fn


def _hybrid_layer(x, mem, w_in, w_mem_kv, q_a_gain, w_q_b, kv_a_gain, w_kv_b,
                  w_branch_mla, w_branch_sb, w_branch_mem, w_merge_gate, b_merge_gate,
                  w_out, ln_gain, ln_bias):
    b, s, _ = x.shape
    pos = jnp.arange(s, dtype=jnp.int32)
    proj = x @ w_in
    (c_q, c_kv, k_rope, gate_a, q_b, k_b, v_b, gate_b, q_m, gate_m) = jnp.split(proj, IN_OFFSETS, axis=-1)

    q_a = (_rms_norm(c_q, q_a_gain) @ w_q_b).reshape(b, s, MLA_HEADS, MLA_NOPE + MLA_ROPE)
    kv_a = (_rms_norm(c_kv, kv_a_gain) @ w_kv_b).reshape(b, s, MLA_HEADS, MLA_NOPE + MLA_V)
    q_nope, q_pe = q_a[..., :MLA_NOPE], q_a[..., MLA_NOPE:]
    k_nope, v_a = kv_a[..., :MLA_NOPE], kv_a[..., MLA_NOPE:]
    k_pe = _rope(k_rope.reshape(b, s, 1, MLA_ROPE), pos)
    q_full = jnp.concatenate([q_nope, _rope(q_pe, pos)], axis=-1)
    k_full = jnp.concatenate([k_nope, jnp.broadcast_to(k_pe, (b, s, MLA_HEADS, MLA_ROPE))], axis=-1)
    o_a = _sweep_query_blocks(q_full, k_full, v_a,
                              _softmax_causal_weights(1.0 / math.sqrt(MLA_NOPE + MLA_ROPE)))
    y_a = (o_a.reshape(b, s, MLA_WIDTH) * jax.nn.silu(gate_a)) @ w_branch_mla

    q_sb = q_b.reshape(b, s, SB_HEADS, SB_HEAD_DIM)
    k_sb = k_b.reshape(b, s, SB_HEADS, SB_HEAD_DIM)
    v_sb = v_b.reshape(b, s, SB_HEADS, SB_HEAD_DIM)
    o_b = _sweep_query_blocks(q_sb, k_sb, v_sb, _stick_breaking_weights(1.0 / math.sqrt(SB_HEAD_DIM)))
    y_b = (o_b.reshape(b, s, SB_WIDTH) * jax.nn.silu(gate_b)) @ w_branch_sb

    mem_kv = (mem @ w_mem_kv).reshape(b, mem.shape[1], 2, MEM_HEADS, MEM_HEAD_DIM)
    k_m, v_m = mem_kv[:, :, 0], mem_kv[:, :, 1]
    q_mh = q_m.reshape(b, s, MEM_HEADS, MEM_HEAD_DIM)
    sc = jnp.einsum('bshd,bmhd->bhsm', q_mh, k_m).astype(jnp.float32) / math.sqrt(MEM_HEAD_DIM)
    p_m = jax.nn.softmax(sc, axis=-1).astype(v_m.dtype)
    o_m = jnp.einsum('bhsm,bmhd->bshd', p_m, v_m).reshape(b, s, MEM_WIDTH)
    y_m = (o_m * jax.nn.silu(gate_m)) @ w_branch_mem

    g = jax.nn.sigmoid(x @ w_merge_gate + b_merge_gate)
    g_a, g_b, g_m = jnp.split(g, N_BRANCHES, axis=-1)
    merged = g_a * y_a + g_b * y_b + g_m * y_m
    out = merged @ w_out

    return _layer_norm(DEEPNORM_ALPHA * x + out, ln_gain, ln_bias)


def setup_inputs(seed: int = 0) -> dict:
    key = jax.random.key(seed)
    ks = jax.random.split(key, 18)
    f32 = jnp.float32

    def nrm(k, shape, fan_in, gain=1.0):
        return jax.random.normal(k, shape, f32) * (gain * fan_in ** -0.5)

    L = DEPTH
    return {
        "x": jax.random.normal(ks[0], (BATCH, SEQ, D_MODEL), f32),
        "mem": jax.random.normal(ks[1], (BATCH, MEM_LEN, D_MODEL), f32),
        "w_in": nrm(ks[2], (L, D_MODEL, IN_WIDTH), D_MODEL),
        "w_mem_kv": nrm(ks[3], (L, D_MODEL, 2 * MEM_WIDTH), D_MODEL),
        "q_a_gain": 1.0 + 0.01 * jax.random.normal(ks[4], (L, MLA_Q_LORA), f32),
        "w_q_b": nrm(ks[5], (L, MLA_Q_LORA, MLA_HEADS * (MLA_NOPE + MLA_ROPE)), MLA_Q_LORA),
        "kv_a_gain": 1.0 + 0.01 * jax.random.normal(ks[6], (L, MLA_KV_LORA), f32),
        "w_kv_b": nrm(ks[7], (L, MLA_KV_LORA, MLA_HEADS * (MLA_NOPE + MLA_V)), MLA_KV_LORA),
        "w_branch_mla": nrm(ks[8], (L, MLA_WIDTH, D_MODEL), MLA_WIDTH, DEEPNORM_BETA),
        "w_branch_sb": nrm(ks[9], (L, SB_WIDTH, D_MODEL), SB_WIDTH, DEEPNORM_BETA),
        "w_branch_mem": nrm(ks[10], (L, MEM_WIDTH, D_MODEL), MEM_WIDTH, DEEPNORM_BETA),
        "w_merge_gate": nrm(ks[11], (L, D_MODEL, N_BRANCHES * D_MODEL), D_MODEL),
        "b_merge_gate": 0.01 * jax.random.normal(ks[12], (L, N_BRANCHES * D_MODEL), f32),
        "w_out": nrm(ks[13], (L, D_MODEL, D_MODEL), D_MODEL, DEEPNORM_BETA),
        "ln_gain": 1.0 + 0.01 * jax.random.normal(ks[14], (L, D_MODEL), f32),
        "ln_bias": 0.01 * jax.random.normal(ks[15], (L, D_MODEL), f32),
    }


def reference(x, mem, w_in, w_mem_kv, q_a_gain, w_q_b, kv_a_gain, w_kv_b,
              w_branch_mla, w_branch_sb, w_branch_mem, w_merge_gate, b_merge_gate,
              w_out, ln_gain, ln_bias):
    h = x
    for l in range(DEPTH):
        h = _hybrid_layer(h, mem, w_in[l], w_mem_kv[l], q_a_gain[l], w_q_b[l], kv_a_gain[l], w_kv_b[l],
                          w_branch_mla[l], w_branch_sb[l], w_branch_mem[l], w_merge_gate[l],
                          b_merge_gate[l], w_out[l], ln_gain[l], ln_bias[l])
    return h
```

```cpp
#include <hip/hip_runtime.h>
#include <hip/hip_cooperative_groups.h>
#include <cstdio>
#include <cstdint>
namespace cg = cooperative_groups;

#define LAS __attribute__((address_space(3)))
typedef unsigned short bf16_t;
typedef short bf16x8 __attribute__((ext_vector_type(8)));
typedef short s16x4 __attribute__((ext_vector_type(4)));
typedef float f32x4 __attribute__((ext_vector_type(4)));
typedef float f32x2 __attribute__((ext_vector_type(2)));
typedef float f32x16 __attribute__((ext_vector_type(16)));
typedef unsigned u32x4 __attribute__((ext_vector_type(4)));
typedef unsigned u32x2 __attribute__((ext_vector_type(2)));
typedef __bf16 bf16x2_t __attribute__((ext_vector_type(2)));

constexpr int D_MODEL = 1024, BATCH = 8, SEQ = 4096, T = BATCH * SEQ, MEM_LEN = 256;
constexpr int PJW = 4096;
constexpr float LOG2E = 1.4426950408889634f;
constexpr float DEEPNORM_ALPHA = 1.189207115002721f;
constexpr int C_GA = 512, C_QB = 1024, C_KB = 1536, C_VB = 2048, C_GB = 2560, C_QM = 3072, C_GM = 3584, C_KR = 384;

constexpr size_t MiB = 1u << 20;
constexpr size_t WS_TAB = 1 * MiB, WS_SSQ = 2 * MiB, WS_STATS = 3 * MiB;
constexpr size_t WS_WCAT = 8 * MiB, WS_WMG = 16 * MiB, WS_WOUT = 22 * MiB, WS_WBR = 24 * MiB, WS_WQ = 27 * MiB, WS_WKV = 27 * MiB + 512 * 1024, WS_WMKV = 28 * MiB;
constexpr size_t WS_MEMB = 30 * MiB, WS_MKV = 34 * MiB, WS_XB = 40 * MiB, WS_OG = 104 * MiB, WS_PJ = 200 * MiB, WS_G = 200 * MiB, WS_MG = 392 * MiB, WS_END = 456 * MiB;
constexpr size_t DO_QF = 0, DO_KF = 48 * MiB, DO_VA = 96 * MiB;

__device__ __forceinline__ unsigned cvtpk(float lo, float hi) { f32x2 v = {lo, hi}; bf16x2_t b = __builtin_convertvector(v, bf16x2_t); return __builtin_bit_cast(unsigned, b); }
__device__ __forceinline__ float bflo(unsigned w) { return __uint_as_float(w << 16); }
__device__ __forceinline__ float bfhi(unsigned w) { return __uint_as_float(w & 0xffff0000u); }
__device__ __forceinline__ void st8(bf16_t* p, f32x4 v0, f32x4 v1) { u32x4 w; w.x = cvtpk(v0[0], v0[1]); w.y = cvtpk(v0[2], v0[3]); w.z = cvtpk(v1[0], v1[1]); w.w = cvtpk(v1[2], v1[3]); *(u32x4*)p = w; }

__device__ __forceinline__ int opaque_tid() { int t = threadIdx.x; asm volatile("" : "+v"(t)); return t; }
namespace pg8 {
constexpr int BM = 256, BK = 64, HALF = 128, HTB = HALF * BK * 2, STAGE_BYTES = 8 * HTB, NXCD = 8, WGM = 8;
__host__ __device__ __forceinline__ int lds_byte(int r, int c) { const int st = (r >> 4) * 2 + (c >> 5), rr = r & 15, cc = c & 31, ob = rr * 64 + cc * 2; return st * 1024 + (ob ^ (((ob >> 9) & 1) << 5)); }
__host__ __device__ __forceinline__ void stage_rc(int b, int& R, int& C) { const int st = b / 1024, sb = b % 1024, swz = sb ^ (((sb >> 9) & 1) << 5); R = (st >> 1) * 16 + swz / 64; C = (st & 1) * 32 + (swz % 64) / 2; }
__host__ __device__ __forceinline__ int perm32(int rho) { const int n = rho >> 4, i = rho & 15; return 8 * (i >> 2) + 4 * n + (i & 3); }

struct Unit { int pm, pn, s; };
struct Gemm { const bf16_t* A; const bf16_t* Bt; int lda, ldb, K; size_t sA, sB; };

struct StaticOrder {
    int nM, nN, nwg, G, c, nsub;
    __device__ void init(int M, int N, int G_, int c_, int nsub_ = 1) { nM = M / BM; nN = N / BM; nwg = nM * nN; G = G_; c = c_; nsub = nsub_; }
    __device__ bool next(int i, Unit& u) const {
        const int round = i / nsub; u.s = i - round * nsub;
        const long L = (long)round * G + c; if (L >= nwg) return false;
        int wgid = (int)L; { const int q = nwg / NXCD, r = nwg % NXCD, xcd = wgid % NXCD, off = wgid / NXCD; wgid = (xcd < r ? xcd * (q + 1) : r * (q + 1) + (xcd - r) * q) + off; }
        const int nig = WGM * nN, gid = wgid / nig, fm = gid * WGM, gsz = (nM - fm) < WGM ? (nM - fm) : WGM;
        u.pm = fm + ((wgid % nig) % gsz); u.pn = (wgid % nig) / gsz; return true;
    }
};
typedef f32x4 Acc[2][2][4][2];

template <class Epi>
__device__ __forceinline__ void gemm_phase(LAS unsigned char* lds, const Gemm g, const StaticOrder& S, const Epi& E) {
    const int tid = opaque_tid(), wid = __builtin_amdgcn_readfirstlane(tid >> 6), lane = tid & 63, wr = wid >> 2, wc = wid & 3, fr = lane & 15, fq = lane >> 4;
    const int K = g.K, nt = K / BK;
    unsigned voffA[2], voffB[2];
#pragma unroll
    for (int i = 0; i < 2; ++i) { int R, C; stage_rc(tid * 16 + i * 8192, R, C); const int Rb = (R & ~31) + perm32(R & 31);
        voffA[i] = (unsigned)(R * g.lda + C) * 2u; voffB[i] = (unsigned)(Rb * g.ldb + C) * 2u; }
    const size_t kstep = (size_t)(BK * 2);
    const size_t hstepA = (size_t)HALF * g.lda * 2, hstepB = (size_t)HALF * g.ldb * 2;
    const size_t tstepA = 2 * hstepA, tstepB = 2 * hstepB;
    const unsigned ldsw = (unsigned)wid * 1024u;
    const int aoff = lds_byte(wr * 64 + fr, fq * 8), boff = lds_byte(wc * 32 + fr, fq * 8);
#define PG8_SA(b, h) (((b) * 2 + (h)) * HTB)
#define PG8_SB(b, h) ((4 + (b) * 2 + (h)) * HTB)
#define PG8_STAGE(bufoff, gbase, voff) do { _Pragma("unroll") for (int _i = 0; _i < 2; ++_i) \
        __builtin_amdgcn_global_load_lds((const unsigned*)((const char*)(gbase) + (voff)[_i]), (LAS unsigned*)(lds + (bufoff) + ldsw + _i * 8192), 16, 0, 0); } while (0)
#define PG8_LDA(dst, b, h) do { _Pragma("unroll") for (int m = 0; m < 4; ++m) _Pragma("unroll") for (int k = 0; k < 2; ++k) dst[m][k] = *(const LAS bf16x8*)(lds + PG8_SA(b, h) + aoff + m * 2048 + k * 1024); } while (0)
#define PG8_LDB(dst, b, h) do { _Pragma("unroll") for (int n = 0; n < 2; ++n) _Pragma("unroll") for (int k = 0; k < 2; ++k) dst[n][k] = *(const LAS bf16x8*)(lds + PG8_SB(b, h) + boff + n * 2048 + k * 1024); } while (0)
#define PG8_MMA(ai, bj, At, Bt) do { __builtin_amdgcn_s_setprio(1); _Pragma("unroll") for (int m = 0; m < 4; ++m) _Pragma("unroll") for (int n = 0; n < 2; ++n) _Pragma("unroll") for (int k = 0; k < 2; ++k) \
        acc[ai][bj][m][n] = __builtin_amdgcn_mfma_f32_16x16x32_bf16(Bt[n][k], At[m][k], acc[ai][bj][m][n], 0, 0, 0); __builtin_amdgcn_s_setprio(0); } while (0)
#define PG8_WAIT_V(n) asm volatile("s_waitcnt vmcnt(" #n ")" ::: "memory")
#define PG8_WAIT_L(n) asm volatile("s_waitcnt lgkmcnt(" #n ")" ::: "memory")
#define PG8_BAR __builtin_amdgcn_s_barrier()
#define PG8_SCHED __builtin_amdgcn_sched_barrier(0)
    Unit cur, nxt; int ui = 0;
    if (!S.next(0, cur)) return;
    Acc acc;
#pragma unroll
    for (int a = 0; a < 2; ++a)
#pragma unroll
        for (int b = 0; b < 2; ++b)
#pragma unroll
            for (int m = 0; m < 4; ++m)
#pragma unroll
                for (int n = 0; n < 2; ++n) acc[a][b][m][n] = (f32x4){0.f, 0.f, 0.f, 0.f};
    bf16x8 At[4][2], B0[2][2], B1[2][2];
    const char* cA = (const char*)g.A + (size_t)cur.pm * tstepA + (size_t)cur.s * g.sA; const char* cB = (const char*)g.Bt + (size_t)cur.pn * tstepB + (size_t)cur.s * g.sB;
    PG8_STAGE(PG8_SB(0, 0), cB, voffB); PG8_STAGE(PG8_SB(0, 1), cB + hstepB, voffB); PG8_STAGE(PG8_SA(0, 0), cA, voffA); PG8_STAGE(PG8_SA(0, 1), cA + hstepA, voffA);
    if (wr == 1) PG8_BAR;
    PG8_WAIT_V(2); PG8_BAR;
    PG8_STAGE(PG8_SB(1, 0), cB + kstep, voffB); PG8_STAGE(PG8_SA(1, 0), cA + kstep, voffA); PG8_STAGE(PG8_SB(1, 1), cB + hstepB + kstep, voffB);
    PG8_WAIT_V(6); PG8_BAR;
    for (;;) {
        const bool has_next = S.next(ui + 1, nxt);
        const char* nA = has_next ? (const char*)g.A + (size_t)nxt.pm * tstepA + (size_t)nxt.s * g.sA : cA; const char* nB = has_next ? (const char*)g.Bt + (size_t)nxt.pn * tstepB + (size_t)nxt.s * g.sB : cB;
        for (int t = 0; t < nt; t += 2) {
            const bool last = (t == nt - 2);
            const char* a1 = cA + (size_t)(t + 1) * kstep;
            const char* a2 = last ? nA : cA + (size_t)(t + 2) * kstep; const char* b2 = last ? nB : cB + (size_t)(t + 2) * kstep;
            const char* a3 = a2 + kstep; const char* b3 = b2 + kstep;
            PG8_LDB(B0, 0, 0); PG8_LDB(B1, 0, 1); PG8_SCHED; PG8_LDA(At, 0, 0); PG8_STAGE(PG8_SA(1, 1), a1 + hstepA, voffA);
            PG8_WAIT_V(8); PG8_WAIT_L(0); PG8_BAR; PG8_MMA(0, 0, At, B0); PG8_MMA(0, 1, At, B1); PG8_BAR; PG8_SCHED;
            PG8_LDA(At, 0, 1); PG8_STAGE(PG8_SB(0, 0), b2, voffB); PG8_STAGE(PG8_SB(0, 1), b2 + hstepB, voffB); PG8_STAGE(PG8_SA(0, 0), a2, voffA);
            PG8_WAIT_V(8); PG8_WAIT_L(0); PG8_BAR; PG8_MMA(1, 0, At, B0); PG8_MMA(1, 1, At, B1); PG8_BAR; PG8_SCHED;
            PG8_LDB(B0, 1, 0); PG8_LDB(B1, 1, 1); PG8_SCHED; PG8_LDA(At, 1, 0); PG8_STAGE(PG8_SA(0, 1), a2 + hstepA, voffA);
            PG8_WAIT_V(8); PG8_WAIT_L(0); PG8_BAR; PG8_MMA(0, 0, At, B0); PG8_MMA(0, 1, At, B1); PG8_BAR; PG8_SCHED;
            PG8_LDA(At, 1, 1); PG8_STAGE(PG8_SB(1, 0), b3, voffB); PG8_STAGE(PG8_SB(1, 1), b3 + hstepB, voffB); PG8_STAGE(PG8_SA(1, 0), a3, voffA);
            PG8_WAIT_V(8); PG8_WAIT_L(0); PG8_BAR; PG8_MMA(1, 0, At, B0); PG8_MMA(1, 1, At, B1); PG8_BAR; PG8_SCHED;
        }
        if (wr == 0) PG8_BAR;
        { int fr_o = fr, fq_o = fq; asm volatile("" : "+v"(fr_o), "+v"(fq_o)); E(acc, cur, wr, wc, fr_o, fq_o); }
        if (!has_next) break;
        if (!Epi::keep(cur)) {
#pragma unroll
            for (int a = 0; a < 2; ++a)
#pragma unroll
                for (int b = 0; b < 2; ++b)
#pragma unroll
                    for (int m = 0; m < 4; ++m)
#pragma unroll
                        for (int n = 0; n < 2; ++n) acc[a][b][m][n] = (f32x4){0.f, 0.f, 0.f, 0.f};
        }
        cur = nxt; cA = nA; cB = nB; ++ui;
        if (wr == 1) PG8_BAR;
    }
    PG8_WAIT_V(0);
    PG8_BAR;
#undef PG8_SA
#undef PG8_SB
#undef PG8_STAGE
#undef PG8_LDA
#undef PG8_LDB
#undef PG8_MMA
#undef PG8_WAIT_V
#undef PG8_WAIT_L
#undef PG8_BAR
#undef PG8_SCHED
}
}
using pg8::Acc; using pg8::Unit; using pg8::HALF;

struct EpiP1 {
    bf16_t* PJ; float* ssq; float sc_sb, sc_m;
    static __device__ __forceinline__ bool keep(const Unit&) { return false; }
    __device__ __forceinline__ void operator()(Acc& acc, const Unit& u, int wr, int wc, int fr, int fq) const {
        const int pn = u.pn; const float sc = (pn == 4 || pn == 5) ? sc_sb : ((pn == 12 || pn == 13) ? sc_m : 1.f);
        const int row0 = u.pm * 256 + wr * 64 + fr, col0 = pn * 256 + wc * 32 + 8 * fq;
#pragma unroll
        for (int ai = 0; ai < 2; ++ai)
#pragma unroll
            for (int m = 0; m < 4; ++m) { bf16_t* rowp = PJ + (unsigned)((row0 + ai * HALF + m * 16) * PJW + col0);
#pragma unroll
                for (int bj = 0; bj < 2; ++bj) st8(rowp + bj * HALF, acc[ai][bj][m][0] * sc, acc[ai][bj][m][1] * sc); }
        if (pn < 2) {
            const int nbj = (pn == 0) ? 2 : 1;
#pragma unroll
            for (int ai = 0; ai < 2; ++ai)
#pragma unroll
                for (int m = 0; m < 4; ++m) { float s = 0.f;
#pragma unroll
                    for (int bj = 0; bj < 2; ++bj) if (bj < nbj)
#pragma unroll
                        for (int n = 0; n < 2; ++n) { const f32x4 x = acc[ai][bj][m][n]; s += (x[0] * x[0] + x[1] * x[1]) + (x[2] * x[2] + x[3] * x[3]); }
                    s += __shfl_xor(s, 16); s += __shfl_xor(s, 32);
                    if (fq == 0) ssq[(unsigned)(pn * T * 4 + (row0 + ai * HALF + m * 16) * 4 + wc)] = s; }
        }
    }
};
struct EpiPlain {
    bf16_t* O; int ldc;
    static __device__ __forceinline__ bool keep(const Unit&) { return false; }
    __device__ __forceinline__ void operator()(Acc& acc, const Unit& u, int wr, int wc, int fr, int fq) const {
        const int row0 = u.pm * 256 + wr * 64 + fr, col0 = u.pn * 256 + wc * 32 + 8 * fq;
#pragma unroll
        for (int ai = 0; ai < 2; ++ai)
#pragma unroll
            for (int m = 0; m < 4; ++m) { bf16_t* rowp = O + (unsigned)((row0 + ai * HALF + m * 16) * ldc + col0);
#pragma unroll
                for (int bj = 0; bj < 2; ++bj) st8(rowp + bj * HALF, acc[ai][bj][m][0], acc[ai][bj][m][1]); }
    }
};
struct EpiQ {
    bf16_t* QF; const float* ssq; const float* tab; float sc;
    static __device__ __forceinline__ bool keep(const Unit&) { return false; }
    __device__ __forceinline__ void operator()(Acc& acc, const Unit& u, int wr, int wc, int fr, int fq) const {
        const int pn = u.pn; const int row0 = u.pm * 256 + wr * 64 + fr;
#pragma unroll
        for (int ai = 0; ai < 2; ++ai)
#pragma unroll
            for (int m = 0; m < 4; ++m) { const int row = row0 + ai * HALF + m * 16; const f32x4 sv = *(const f32x4*)(ssq + (unsigned)(row * 4));
                const float r = rsqrtf(((sv[0] + sv[1]) + (sv[2] + sv[3])) * (1.f / 256.f) + 1e-6f) * sc;
                if (pn < 2) {
#pragma unroll
                    for (int bj = 0; bj < 2; ++bj) { const int head = pn * 4 + 2 * bj + (wc >> 1), d = (wc & 1) * 32 + 8 * fq; st8(QF + (unsigned)(row * 768 + head * 96 + d), acc[ai][bj][m][0] * r, acc[ai][bj][m][1] * r); }
                } else {
                    const int head = (pn - 2) * 4 + wc, pos = row & (SEQ - 1); f32x4 v[2];
#pragma unroll
                    for (int n = 0; n < 2; ++n) { const f32x4 cs = *(const f32x4*)(tab + (unsigned)(pos * 32 + 8 * (fq & 1) + 4 * n)), sn = *(const f32x4*)(tab + (unsigned)(pos * 32 + 16 + 8 * (fq & 1) + 4 * n));
                        v[n] = (cs * acc[ai][0][m][n] + sn * acc[ai][1][m][n]) * r; }
                    st8(QF + (unsigned)(row * 768 + head * 96 + 64 + 8 * fq), v[0], v[1]);
                } }
    }
};
struct EpiKV {
    bf16_t* KF; bf16_t* VA; const float* ssq;
    static __device__ __forceinline__ bool keep(const Unit&) { return false; }
    __device__ __forceinline__ void operator()(Acc& acc, const Unit& u, int wr, int wc, int fr, int fq) const {
        const int pn = u.pn; const int row0 = u.pm * 256 + wr * 64 + fr;
#pragma unroll
        for (int ai = 0; ai < 2; ++ai)
#pragma unroll
            for (int m = 0; m < 4; ++m) { const int row = row0 + ai * HALF + m * 16; const f32x4 sv = *(const f32x4*)(ssq + (unsigned)(row * 4));
                const float r = rsqrtf(((sv[0] + sv[1]) + (sv[2] + sv[3])) * (1.f / 128.f) + 1e-6f);
#pragma unroll
                for (int bj = 0; bj < 2; ++bj) { const int head = (pn & 1) * 4 + 2 * bj + (wc >> 1), d = (wc & 1) * 32 + 8 * fq;
                    bf16_t* p = (pn < 2) ? (KF + (unsigned)(row * 768 + head * 96 + d)) : (VA + (unsigned)(row * 512 + head * 64 + d));
                    st8(p, acc[ai][bj][m][0] * r, acc[ai][bj][m][1] * r); } }
    }
};
__device__ __forceinline__ float sigmoidf_(float x) { return __builtin_amdgcn_rcpf(1.f + __expf(-x)); }
struct EpiGate {
    bf16_t* G; const float* bias;
    static __device__ __forceinline__ bool keep(const Unit&) { return false; }
    __device__ __forceinline__ void operator()(Acc& acc, const Unit& u, int wr, int wc, int fr, int fq) const {
        const int row0 = u.pm * 256 + wr * 64 + fr, col0 = u.pn * 256 + wc * 32 + 8 * fq;
        f32x4 bv[2][2];
#pragma unroll
        for (int bj = 0; bj < 2; ++bj)
#pragma unroll
            for (int n = 0; n < 2; ++n) bv[bj][n] = *(const f32x4*)(bias + col0 + bj * HALF + 4 * n);
#pragma unroll
        for (int ai = 0; ai < 2; ++ai)
#pragma unroll
            for (int m = 0; m < 4; ++m) { bf16_t* rowp = G + (unsigned)((row0 + ai * HALF + m * 16) * 3072 + col0);
#pragma unroll
                for (int bj = 0; bj < 2; ++bj) { f32x4 v[2];
#pragma unroll
                    for (int n = 0; n < 2; ++n) { const f32x4 z = acc[ai][bj][m][n] + bv[bj][n];
#pragma unroll
                        for (int j = 0; j < 4; ++j) v[n][j] = fmaxf(sigmoidf_(z[j]), 1e-30f); }
                    st8(rowp + bj * HALF, v[0], v[1]); } }
    }
};
struct EpiMerge {
    const bf16_t* G; bf16_t* MG;
    static __device__ __forceinline__ bool keep(const Unit& u) { return u.s < 2; }
    __device__ __forceinline__ void operator()(Acc& acc, const Unit& u, int wr, int wc, int fr, int fq) const {
        const int s = u.s; const int row0 = u.pm * 256 + wr * 64 + fr, col0 = u.pn * 256 + wc * 32 + 8 * fq;
#pragma unroll
        for (int ai = 0; ai < 2; ++ai)
#pragma unroll
            for (int m = 0; m < 4; ++m) { const unsigned row = (unsigned)(row0 + ai * HALF + m * 16);
#pragma unroll
                for (int bj = 0; bj < 2; ++bj) { const u32x4 ga = *(const u32x4*)(G + row * 3072 + s * 1024 + col0 + bj * HALF);
                    f32x4 g0 = {bflo(ga.x), bfhi(ga.x), bflo(ga.y), bfhi(ga.y)}, g1 = {bflo(ga.z), bfhi(ga.z), bflo(ga.w), bfhi(ga.w)};
                    if (s < 2) { const u32x4 gb = *(const u32x4*)(G + row * 3072 + (s + 1) * 1024 + col0 + bj * HALF);
                        const f32x4 h0 = {bflo(gb.x), bfhi(gb.x), bflo(gb.y), bfhi(gb.y)}, h1 = {bflo(gb.z), bfhi(gb.z), bflo(gb.w), bfhi(gb.w)};
#pragma unroll
                        for (int j = 0; j < 4; ++j) { g0[j] = g0[j] / h0[j]; g1[j] = g1[j] / h1[j]; }
                        acc[ai][bj][m][0] *= g0; acc[ai][bj][m][1] *= g1;
                    } else st8(MG + row * 1024 + col0 + bj * HALF, acc[ai][bj][m][0] * g0, acc[ai][bj][m][1] * g1); } }
    }
};
struct EpiOut {
    const float* x; float* out; float* stats;
    static __device__ __forceinline__ bool keep(const Unit&) { return false; }
    __device__ __forceinline__ void operator()(Acc& acc, const Unit& u, int wr, int wc, int fr, int fq) const {
        const int row0 = u.pm * 256 + wr * 64 + fr, col0 = u.pn * 256 + wc * 32 + 8 * fq;
#pragma unroll
        for (int ai = 0; ai < 2; ++ai)
#pragma unroll
            for (int m = 0; m < 4; ++m) { const unsigned row = (unsigned)(row0 + ai * HALF + m * 16); float s1 = 0.f, s2 = 0.f;
#pragma unroll
                for (int bj = 0; bj < 2; ++bj)
#pragma unroll
                    for (int n = 0; n < 2; ++n) { const unsigned off = row * 1024 + col0 + bj * HALF + 4 * n; const f32x4 xv = *(const f32x4*)(x + off);
                        const f32x4 v = xv * DEEPNORM_ALPHA + acc[ai][bj][m][n]; *(f32x4*)(out + off) = v;
                        s1 += (v[0] + v[1]) + (v[2] + v[3]); s2 += (v[0] * v[0] + v[1] * v[1]) + (v[2] * v[2] + v[3] * v[3]); }
                s1 += __shfl_xor(s1, 16); s1 += __shfl_xor(s1, 32); s2 += __shfl_xor(s2, 16); s2 += __shfl_xor(s2, 32);
                if (fq == 0) *(f32x2*)(stats + (row * 16 + u.pn * 4 + wc) * 2) = (f32x2){s1, s2}; }
    }
};

__device__ __forceinline__ int crow(int r, int hi) { return (r & 3) + 8 * (r >> 2) + 4 * hi; }
__device__ __forceinline__ float swap_max(float v) { auto rr = __builtin_amdgcn_permlane32_swap(__float_as_uint(v), __float_as_uint(v), false, false); return fmaxf(__uint_as_float(rr[0]), __uint_as_float(rr[1])); }
__device__ __forceinline__ float swap_sum(float v) { auto rr = __builtin_amdgcn_permlane32_swap(__float_as_uint(v), __float_as_uint(v), false, false); return __uint_as_float(rr[0]) + __uint_as_float(rr[1]); }
typedef short v4i16_t __attribute__((ext_vector_type(4)));
__device__ __forceinline__ s16x4 vtr(const LAS unsigned char* p) { return __builtin_bit_cast(s16x4, __builtin_amdgcn_ds_read_tr16_b64_v4i16((LAS v4i16_t*)p)); }

constexpr float SB_EXIT_LOG2 = -160.f;

template <int DQK, int DV, int MODE>
__device__ __forceinline__ void attn_unit(LAS unsigned char* lds, const bf16_t* Qp, int ldq, const bf16_t* Kp, int ldk, const bf16_t* Vp, int ldv,
                                          const bf16_t* Gp, int ldg, bf16_t* Op, int ldo, int q0, int NT) {
    constexpr int KCH = DQK / 8, KSTR = DQK * 2 + 16, KBUF = 64 * KSTR, VCH = DV / 8, VBUF = (DV / 32) * 4096;
    constexpr int NKC = 64 * KCH, NVC = 64 * VCH, KPT = (NKC + 511) / 512, VPT = NVC / 512, ND = DQK / 16, NO = DV / 32;
    constexpr int FLAG_OFF = 2 * KBUF + 2 * VBUF;
    const int tid = opaque_tid(), lane = tid & 63, r32 = lane & 31, hi = lane >> 5; const int wid = __builtin_amdgcn_readfirstlane(tid >> 6);
    volatile LAS unsigned* flags = (volatile LAS unsigned*)(lds + FLAG_OFF);
    const int qmin = q0 + 32 * wid, q = qmin + r32;
    bf16x8 qr[ND];
#pragma unroll
    for (int d0 = 0; d0 < ND; ++d0) qr[d0] = *(const bf16x8*)(Qp + (size_t)q * ldq + d0 * 16 + 8 * hi);
    u32x4 kreg[KPT], vreg[VPT];
    auto g_load = [&](int t) {
        const int k0 = 64 * t;
#pragma unroll
        for (int i = 0; i < KPT; ++i) { const int idx = tid + 512 * i; if (idx < NKC) { const int key = idx / KCH, c = idx - key * KCH; kreg[i] = *(const u32x4*)(Kp + (size_t)(k0 + key) * ldk + c * 8); } }
#pragma unroll
        for (int i = 0; i < VPT; ++i) { const int idx = tid + 512 * i; const int key = idx / VCH, c = idx - key * VCH; vreg[i] = *(const u32x4*)(Vp + (size_t)(k0 + key) * ldv + c * 8); }
    };
    auto l_store = [&](int buf) {
#pragma unroll
        for (int i = 0; i < KPT; ++i) { const int idx = tid + 512 * i; if (idx < NKC) { const int key = idx / KCH, c = idx - key * KCH; *(LAS u32x4*)(lds + buf * KBUF + key * KSTR + c * 16) = kreg[i]; } }
#pragma unroll
        for (int i = 0; i < VPT; ++i) { const int idx = tid + 512 * i; const int key = idx / VCH, c = idx - key * VCH, dv0 = c * 8;
            *(LAS u32x4*)(lds + 2 * KBUF + buf * VBUF + (dv0 >> 5) * 4096 + (key >> 3) * 512 + (key & 7) * 64 + (dv0 & 31) * 2) = vreg[i]; }
    };
    f32x16 o[NO];
#pragma unroll
    for (int d = 0; d < NO; ++d)
#pragma unroll
        for (int r = 0; r < 16; ++r) o[d][r] = 0.f;
    float mrun = -1e30f, lsum = 0.f, carry = 0.f;
    const int vlane = ((lane >> 4) & 1) * 32 + (lane & 3) * 8 + (4 * hi + ((lane & 15) >> 2)) * 64;
    if (MODE == 1 && tid < 3) flags[tid] = 0u;
    g_load(MODE == 1 ? NT - 1 : 0); l_store(0);
    __syncthreads();
    for (int it = 0; it < NT; ++it) {
        const int t = (MODE == 1) ? NT - 1 - it : it; const int k0 = 64 * t; const int buf = it & 1;
        const bool more = it + 1 < NT;
        if (more) g_load(MODE == 1 ? t - 1 : t + 1);
        const bool active = (MODE == 0) ? (k0 <= qmin + 31) : ((MODE == 1) ? (k0 < qmin + 31) : true);
        if (active) {
            f32x16 p0, p1;
#pragma unroll
            for (int r = 0; r < 16; ++r) { p0[r] = 0.f; p1[r] = 0.f; }
            const LAS unsigned char* kb = lds + buf * KBUF + r32 * KSTR + hi * 16;
#pragma unroll
            for (int d0 = 0; d0 < ND; ++d0) { const bf16x8 ka = *(const LAS bf16x8*)(kb + d0 * 32), kc = *(const LAS bf16x8*)(kb + 32 * KSTR + d0 * 32);
                p0 = __builtin_amdgcn_mfma_f32_32x32x16_bf16(ka, qr[d0], p0, 0, 0, 0); p1 = __builtin_amdgcn_mfma_f32_32x32x16_bf16(kc, qr[d0], p1, 0, 0, 0); }
            if (MODE == 0) { if (k0 + 63 > qmin) {
#pragma unroll
                for (int r = 0; r < 16; ++r) { const int kv = k0 + crow(r, hi); if (kv > q) p0[r] = -INFINITY; if (kv + 32 > q) p1[r] = -INFINITY; } } }
            if (MODE == 1) { if (k0 + 63 >= qmin) {
#pragma unroll
                for (int r = 0; r < 16; ++r) { const int kv = k0 + crow(r, hi); if (kv >= q) p0[r] = -INFINITY; if (kv + 32 >= q) p1[r] = -INFINITY; } } }
            u32x4 pw[4];
            if (MODE != 1) {
                float mx = fmaxf(p0[0], p1[0]);
#pragma unroll
                for (int r = 1; r < 16; ++r) mx = fmaxf(mx, fmaxf(p0[r], p1[r]));
                mx = swap_max(mx);
                const float mnew = fmaxf(mrun, mx), alpha = __builtin_amdgcn_exp2f(mrun - mnew); mrun = mnew;
                float s = 0.f;
#pragma unroll
                for (int r = 0; r < 16; ++r) { p0[r] = __builtin_amdgcn_exp2f(p0[r] - mnew); p1[r] = __builtin_amdgcn_exp2f(p1[r] - mnew); s += p0[r] + p1[r]; }
                lsum = lsum * alpha + s;
#pragma unroll
                for (int d = 0; d < NO; ++d)
#pragma unroll
                    for (int r = 0; r < 16; ++r) o[d][r] *= alpha;
            } else {
                f32x16 l0, l1; float tg[8];
#pragma unroll
                for (int r = 0; r < 16; ++r) {
                    const float a0 = p0[r], a1 = p1[r];
                    l0[r] = -(fmaxf(a0, 0.f) + __builtin_amdgcn_logf(1.f + __builtin_amdgcn_exp2f(-fabsf(a0))));
                    l1[r] = -(fmaxf(a1, 0.f) + __builtin_amdgcn_logf(1.f + __builtin_amdgcn_exp2f(-fabsf(a1))));
                }
#pragma unroll
                for (int g = 0; g < 4; ++g) { tg[g] = (l0[4 * g] + l0[4 * g + 1]) + (l0[4 * g + 2] + l0[4 * g + 3]); tg[4 + g] = (l1[4 * g] + l1[4 * g + 1]) + (l1[4 * g + 2] + l1[4 * g + 3]); }
                float run = carry, eg[8];
#pragma unroll
                for (int g = 7; g >= 0; --g) { auto rr = __builtin_amdgcn_permlane32_swap(__float_as_uint(tg[g]), __float_as_uint(tg[g]), false, false);
                    const float tlo = __uint_as_float(rr[0]), thi = __uint_as_float(rr[1]);
                    const float ehi = run; run += thi; const float elo = run; run += tlo; eg[g] = hi ? ehi : elo; }
                carry = run;
#pragma unroll
                for (int g = 0; g < 4; ++g) {
                    float s3 = eg[g], s2 = s3 + l0[4 * g + 3], s1 = s2 + l0[4 * g + 2], s0 = s1 + l0[4 * g + 1];
                    p0[4 * g + 3] = __builtin_amdgcn_exp2f(p0[4 * g + 3] + l0[4 * g + 3] + s3); p0[4 * g + 2] = __builtin_amdgcn_exp2f(p0[4 * g + 2] + l0[4 * g + 2] + s2);
                    p0[4 * g + 1] = __builtin_amdgcn_exp2f(p0[4 * g + 1] + l0[4 * g + 1] + s1); p0[4 * g] = __builtin_amdgcn_exp2f(p0[4 * g] + l0[4 * g] + s0);
                    s3 = eg[4 + g]; s2 = s3 + l1[4 * g + 3]; s1 = s2 + l1[4 * g + 2]; s0 = s1 + l1[4 * g + 1];
                    p1[4 * g + 3] = __builtin_amdgcn_exp2f(p1[4 * g + 3] + l1[4 * g + 3] + s3); p1[4 * g + 2] = __builtin_amdgcn_exp2f(p1[4 * g + 2] + l1[4 * g + 2] + s2);
                    p1[4 * g + 1] = __builtin_amdgcn_exp2f(p1[4 * g + 1] + l1[4 * g + 1] + s1); p1[4 * g] = __builtin_amdgcn_exp2f(p1[4 * g] + l1[4 * g] + s0);
                }
            }
            pw[0] = (u32x4){cvtpk(p0[0], p0[1]), cvtpk(p0[2], p0[3]), cvtpk(p0[4], p0[5]), cvtpk(p0[6], p0[7])};
            pw[1] = (u32x4){cvtpk(p0[8], p0[9]), cvtpk(p0[10], p0[11]), cvtpk(p0[12], p0[13]), cvtpk(p0[14], p0[15])};
            pw[2] = (u32x4){cvtpk(p1[0], p1[1]), cvtpk(p1[2], p1[3]), cvtpk(p1[4], p1[5]), cvtpk(p1[6], p1[7])};
            pw[3] = (u32x4){cvtpk(p1[8], p1[9]), cvtpk(p1[10], p1[11]), cvtpk(p1[12], p1[13]), cvtpk(p1[14], p1[15])};
            const LAS unsigned char* vb = lds + 2 * KBUF + buf * VBUF + vlane;
#pragma unroll
            for (int d = 0; d < NO; ++d)
#pragma unroll
                for (int s = 0; s < 4; ++s) { const s16x4 lo = vtr(vb + d * 4096 + s * 1024), hh = vtr(vb + d * 4096 + s * 1024 + 512);
                    const bf16x8 vf = {lo[0], lo[1], lo[2], lo[3], hh[0], hh[1], hh[2], hh[3]};
                    o[d] = __builtin_amdgcn_mfma_f32_32x32x16_bf16(vf, __builtin_bit_cast(bf16x8, pw[s]), o[d], 0, 0, 0); }
        }
        if (more) l_store(buf ^ 1);
        if (MODE == 1) {
            const int slot = it % 3;
            const bool wdone = __all(carry < SB_EXIT_LOG2) != 0;
            if (!wdone && lane == 0) flags[slot] = 1u;
            __syncthreads();
            const bool alldone = flags[slot] == 0u;
            if (tid == 0) flags[(it + 2) % 3] = 0u;
            if (alldone) break;
        } else __syncthreads();
    }
    float inv = 1.f;
    if (MODE != 1) inv = 1.f / swap_sum(lsum);
#pragma unroll
    for (int d = 0; d < NO; ++d)
#pragma unroll
        for (int g = 0; g < 4; ++g) { const int dv0 = 32 * d + 8 * g + 4 * hi;
            const u32x2 gw = *(const u32x2*)(Gp + (size_t)q * ldg + dv0);
            const float g0 = bflo(gw.x), g1 = bfhi(gw.x), g2 = bflo(gw.y), g3 = bfhi(gw.y);
            const float v0 = o[d][4 * g] * inv * g0 * sigmoidf_(g0), v1 = o[d][4 * g + 1] * inv * g1 * sigmoidf_(g1), v2 = o[d][4 * g + 2] * inv * g2 * sigmoidf_(g2), v3 = o[d][4 * g + 3] * inv * g3 * sigmoidf_(g3);
            u32x2 w; w.x = cvtpk(v0, v1); w.y = cvtpk(v2, v3); *(u32x2*)(Op + (size_t)q * ldo + dv0) = w; }
    __syncthreads();
}

__device__ __forceinline__ void map_col(int mat, int n, int& src, float& sg) {
    sg = 1.f; src = n;
    if (mat == 0) { src = (n < 416) ? n : ((n < 512) ? -1 : n - 96); }
    else if (mat == 6) {
        if (n < 512) { src = (n >> 6) * 96 + (n & 63); }
        else { const int t = (n - 512) >> 8, c = (n - 512) & 255, cc = c & 127, head = t * 4 + (cc >> 5), i = cc & 31;
            if (c < 128) src = head * 96 + 64 + i; else if (i < 16) { src = head * 96 + 64 + i + 16; sg = -1.f; } else src = head * 96 + 64 + i - 16; }
    } else if (mat == 7) { if (n < 512) src = (n >> 6) * 128 + (n & 63); else src = ((n - 512) >> 6) * 128 + 64 + (n & 63); }
}
__device__ __forceinline__ void transpose_item(const float* W, int Nsrc, int K, int Ndst, bf16_t* WT, int mat, const float* gain, LAS float* scr, int item, int lane) {
    const int nblk = Ndst / 32, kb = item / nblk, nb = item - kb * nblk, k0 = 64 * kb, n0 = 32 * nb;
    int src; float sg; map_col(mat, n0 + (lane & 31), src, sg);
#pragma unroll 8
    for (int i = 0; i < 32; ++i) { const int kk = 2 * i + (lane >> 5); float v = 0.f; if (src >= 0) { v = W[(size_t)(k0 + kk) * Nsrc + src] * sg; if (gain) v *= gain[k0 + kk]; } scr[kk * 33 + (lane & 31)] = v; }
    asm volatile("s_waitcnt lgkmcnt(0)" ::: "memory");
    const int c = lane & 7;
#pragma unroll
    for (int j = 0; j < 4; ++j) { const int n = (lane >> 3) + 8 * j; const LAS float* s = scr + (8 * c) * 33 + n;
        u32x4 o; o.x = cvtpk(s[0 * 33], s[1 * 33]); o.y = cvtpk(s[2 * 33], s[3 * 33]); o.z = cvtpk(s[4 * 33], s[5 * 33]); o.w = cvtpk(s[6 * 33], s[7 * 33]);
        *(u32x4*)(WT + (size_t)(n0 + n) * K + k0 + 8 * c) = o; }
    asm volatile("s_waitcnt lgkmcnt(0)" ::: "memory");
}

struct Params {
    const float* x; const float* mem; const float* w_in; const float* w_mem_kv; const float* q_a_gain; const float* w_q_b; const float* kv_a_gain; const float* w_kv_b;
    const float* w_br[3]; const float* w_mg; const float* b_mg; const float* w_out; const float* ln_g; const float* ln_b;
    float* out; unsigned char* ws; int ph_lo, ph_hi;
};

constexpr int LDS_BYTES = 147456;

__global__ void __launch_bounds__(512) fwd_kernel(Params P) {
    extern __shared__ __attribute__((aligned(16))) unsigned char lds_raw[];
    LAS unsigned char* lds = (LAS unsigned char*)lds_raw;
    __builtin_assume(__builtin_amdgcn_workitem_id_y() == 0); __builtin_assume(__builtin_amdgcn_workitem_id_z() == 0);
    cg::grid_group grid = cg::this_grid();
    const int G = gridDim.x, bx = blockIdx.x;
    const int vcu = (G % 8 == 0) ? (bx % 8) * (G / 8) + bx / 8 : bx;
    unsigned char* ws = P.ws;
    float* TAB = (float*)(ws + WS_TAB); float* SSQ = (float*)(ws + WS_SSQ); float* STATS = (float*)(ws + WS_STATS);
    bf16_t* WCAT = (bf16_t*)(ws + WS_WCAT); bf16_t* WMG = (bf16_t*)(ws + WS_WMG); bf16_t* WOUT = (bf16_t*)(ws + WS_WOUT); bf16_t* WBR = (bf16_t*)(ws + WS_WBR);
    bf16_t* WQ = (bf16_t*)(ws + WS_WQ); bf16_t* WKV = (bf16_t*)(ws + WS_WKV); bf16_t* WMKV = (bf16_t*)(ws + WS_WMKV);
    bf16_t* MEMB = (bf16_t*)(ws + WS_MEMB); bf16_t* MKV = (bf16_t*)(ws + WS_MKV); bf16_t* XB = (bf16_t*)(ws + WS_XB); bf16_t* OG = (bf16_t*)(ws + WS_OG);
    bf16_t* PJ = (bf16_t*)(ws + WS_PJ); bf16_t* GB = (bf16_t*)(ws + WS_G); bf16_t* MGB = (bf16_t*)(ws + WS_MG);
    bf16_t* QF = (bf16_t*)((unsigned char*)P.out + DO_QF); bf16_t* KF = (bf16_t*)((unsigned char*)P.out + DO_KF); bf16_t* VA = (bf16_t*)((unsigned char*)P.out + DO_VA);
    const int lo = P.ph_lo, hi_ = P.ph_hi;
#define IN(k) (lo <= (k) && (k) < hi_)
#define SEAM(k) do { if (IN(k) && IN((k) + 1)) grid.sync(); } while (0)

    if (IN(0)) {
        const int tid = opaque_tid(), lane = tid & 63, wave = __builtin_amdgcn_readfirstlane(tid >> 6);
        LAS float* scr = (LAS float*)(lds + wave * 16384);
        const int gw = vcu * 8 + wave, NGW = G * 8;
        constexpr int I0 = 16 * 128, I1 = 16 * 96, I2 = 16 * 32, I3 = 8 * 32, I6 = 4 * 32, I7 = 2 * 32, I8 = 16 * 32;
        constexpr int NITEMS = I0 + I1 + I2 + 3 * I3 + I6 + I7 + I8;
        for (int it = gw; it < NITEMS; it += NGW) {
            int r = it;
            if (r < I0) { transpose_item(P.w_in, 4000, 1024, 4096, WCAT, 0, nullptr, scr, r, lane); continue; } r -= I0;
            if (r < I1) { transpose_item(P.w_mg, 3072, 1024, 3072, WMG, 1, nullptr, scr, r, lane); continue; } r -= I1;
            if (r < I2) { transpose_item(P.w_out, 1024, 1024, 1024, WOUT, 2, nullptr, scr, r, lane); continue; } r -= I2;
            if (r < 3 * I3) { const int b = r / I3; transpose_item(P.w_br[b], 1024, 512, 1024, WBR + (size_t)b * 1024 * 512, 3, nullptr, scr, r - b * I3, lane); continue; } r -= 3 * I3;
            if (r < I6) { transpose_item(P.w_q_b, 768, 256, 1024, WQ, 6, P.q_a_gain, scr, r, lane); continue; } r -= I6;
            if (r < I7) { transpose_item(P.w_kv_b, 1024, 128, 1024, WKV, 7, P.kv_a_gain, scr, r, lane); continue; } r -= I7;
            transpose_item(P.w_mem_kv, 1024, 1024, 1024, WMKV, 8, nullptr, scr, r, lane);
        }
        const size_t gt = (size_t)vcu * 512 + tid, NTH = (size_t)G * 512;
        for (size_t i = gt; i < (size_t)T * 1024 / 8; i += NTH) { const f32x4 a = *(const f32x4*)(P.x + i * 8), b = *(const f32x4*)(P.x + i * 8 + 4); st8(XB + i * 8, a, b); }
        for (size_t i = gt; i < (size_t)BATCH * MEM_LEN * 1024 / 8; i += NTH) { const f32x4 a = *(const f32x4*)(P.mem + i * 8), b = *(const f32x4*)(P.mem + i * 8 + 4); st8(MEMB + i * 8, a, b); }
        for (size_t i = gt; i < (size_t)SEQ * 16; i += NTH) { const int pos = (int)(i >> 4), k = (int)(i & 15);
            const double b4 = (k & 3) == 0 ? 1.0 : ((k & 3) == 1 ? 0.5623413251903491 : ((k & 3) == 2 ? 0.31622776601683794 : 0.17782794100389228));
            const double dec = (k >> 2) == 0 ? 1.0 : ((k >> 2) == 1 ? 0.1 : ((k >> 2) == 2 ? 0.01 : 0.001));
            const float freq = (float)(b4 * dec); const float ang = (float)pos * freq;
            const double rev = (double)ang * 0.15915494309189535; const float fr_ = (float)(rev - __builtin_rint(rev));
            TAB[(size_t)pos * 32 + k] = __builtin_amdgcn_cosf(fr_); TAB[(size_t)pos * 32 + 16 + k] = __builtin_amdgcn_sinf(fr_); }
    }
    SEAM(0);
    if (IN(1)) {
        { pg8::Gemm g{XB, WCAT, 1024, 1024, 1024, 0, 0}; pg8::StaticOrder S; S.init(T, PJW, G, bx);
          EpiP1 E{PJ, SSQ, 0.125f * LOG2E, 0.08838834764831845f * LOG2E};
          pg8::gemm_phase(lds, g, S, E); }
        { pg8::Gemm g{MEMB, WMKV, 1024, 1024, 1024, 0, 0}; pg8::StaticOrder S; S.init(BATCH * MEM_LEN, 1024, G, bx);
          EpiPlain E{MKV, 1024};
          pg8::gemm_phase(lds, g, S, E); }
    }
    SEAM(1);
    if (IN(2)) {
        { pg8::Gemm g{PJ, WQ, PJW, 256, 256, 0, 0}; pg8::StaticOrder S; S.init(T, 1024, G, bx);
          EpiQ E{QF, SSQ, TAB, 0.10206207261596577f * LOG2E};
          pg8::gemm_phase(lds, g, S, E); }
        { pg8::Gemm g{PJ + 256, WKV, PJW, 128, 128, 0, 0}; pg8::StaticOrder S; S.init(T, 1024, G, bx);
          EpiKV E{KF, VA, SSQ + (size_t)T * 4};
          pg8::gemm_phase(lds, g, S, E); }
        const int tid = opaque_tid();
        const size_t gt = (size_t)vcu * 512 + tid, NTH = (size_t)G * 512;
        for (size_t i = gt; i < (size_t)T * 8; i += NTH) { const size_t row = i >> 3; const int h = (int)(i & 7), pos = (int)(row & (SEQ - 1));
            const u32x4 xa = *(const u32x4*)(PJ + row * PJW + C_KR), xb = *(const u32x4*)(PJ + row * PJW + C_KR + 8), xc = *(const u32x4*)(PJ + row * PJW + C_KR + 16), xd = *(const u32x4*)(PJ + row * PJW + C_KR + 24);
            float x1[16], x2[16];
            x1[0] = bflo(xa.x); x1[1] = bfhi(xa.x); x1[2] = bflo(xa.y); x1[3] = bfhi(xa.y); x1[4] = bflo(xa.z); x1[5] = bfhi(xa.z); x1[6] = bflo(xa.w); x1[7] = bfhi(xa.w);
            x1[8] = bflo(xb.x); x1[9] = bfhi(xb.x); x1[10] = bflo(xb.y); x1[11] = bfhi(xb.y); x1[12] = bflo(xb.z); x1[13] = bfhi(xb.z); x1[14] = bflo(xb.w); x1[15] = bfhi(xb.w);
            x2[0] = bflo(xc.x); x2[1] = bfhi(xc.x); x2[2] = bflo(xc.y); x2[3] = bfhi(xc.y); x2[4] = bflo(xc.z); x2[5] = bfhi(xc.z); x2[6] = bflo(xc.w); x2[7] = bfhi(xc.w);
            x2[8] = bflo(xd.x); x2[9] = bfhi(xd.x); x2[10] = bflo(xd.y); x2[11] = bfhi(xd.y); x2[12] = bflo(xd.z); x2[13] = bfhi(xd.z); x2[14] = bflo(xd.w); x2[15] = bfhi(xd.w);
            float o1[16], o2[16];
#pragma unroll
            for (int j = 0; j < 4; ++j) { const f32x4 cs = *(const f32x4*)(TAB + (size_t)pos * 32 + 4 * j), sn = *(const f32x4*)(TAB + (size_t)pos * 32 + 16 + 4 * j);
#pragma unroll
                for (int e = 0; e < 4; ++e) { o1[4 * j + e] = x1[4 * j + e] * cs[e] - x2[4 * j + e] * sn[e]; o2[4 * j + e] = x1[4 * j + e] * sn[e] + x2[4 * j + e] * cs[e]; } }
            bf16_t* dst = KF + row * 768 + h * 96 + 64;
            st8(dst, (f32x4){o1[0], o1[1], o1[2], o1[3]}, (f32x4){o1[4], o1[5], o1[6], o1[7]}); st8(dst + 8, (f32x4){o1[8], o1[9], o1[10], o1[11]}, (f32x4){o1[12], o1[13], o1[14], o1[15]});
            st8(dst + 16, (f32x4){o2[0], o2[1], o2[2], o2[3]}, (f32x4){o2[4], o2[5], o2[6], o2[7]}); st8(dst + 24, (f32x4){o2[8], o2[9], o2[10], o2[11]}, (f32x4){o2[12], o2[13], o2[14], o2[15]}); }
    }
    SEAM(2);
    if (IN(3)) {
        for (int u = vcu; u < 1024; u += G) { const int i = u >> 8, v = u & 255, bh = v >> 2, j = v & 3, b = bh >> 3, h = bh & 7;
            const int qb = (i == 0) ? 15 - j : ((i == 1) ? 8 + j : ((i == 2) ? 7 - j : j));
            const size_t r0 = (size_t)b * SEQ;
            attn_unit<96, 64, 0>(lds, QF + r0 * 768 + h * 96, 768, KF + r0 * 768 + h * 96, 768, VA + r0 * 512 + h * 64, 512, PJ + r0 * PJW + C_GA + h * 64, PJW, OG + r0 * 1536 + h * 64, 1536, qb * 256, 4 * (qb + 1)); }
        for (int u = vcu; u < 1024; u += G) { const int i = u >> 8, v = u & 255, bh = v >> 2, j = v & 3, b = bh >> 3, h = bh & 7, qb = 4 * i + j;
            const size_t r0 = (size_t)b * SEQ;
            attn_unit<64, 64, 1>(lds, PJ + r0 * PJW + C_QB + h * 64, PJW, PJ + r0 * PJW + C_KB + h * 64, PJW, PJ + r0 * PJW + C_VB + h * 64, PJW, PJ + r0 * PJW + C_GB + h * 64, PJW, OG + r0 * 1536 + 512 + h * 64, 1536, qb * 256, 4 * (qb + 1)); }
        for (int u = vcu; u < 512; u += G) { const int i = u >> 8, v = u & 255, bh = v >> 3, b = bh >> 2, h = bh & 3, qb = (v & 7) * 2 + i;
            const size_t r0 = (size_t)b * SEQ, m0 = (size_t)b * MEM_LEN;
            attn_unit<128, 128, 2>(lds, PJ + r0 * PJW + C_QM + h * 128, PJW, MKV + m0 * 1024 + h * 128, 1024, MKV + m0 * 1024 + 512 + h * 128, 1024, PJ + r0 * PJW + C_GM + h * 128, PJW, OG + r0 * 1536 + 1024 + h * 128, 1536, qb * 256, 4); }
    }
    SEAM(3);
    if (IN(4)) {
        pg8::Gemm g{XB, WMG, 1024, 1024, 1024, 0, 0}; pg8::StaticOrder S; S.init(T, 3072, G, bx);
        EpiGate E{GB, P.b_mg};
        pg8::gemm_phase(lds, g, S, E);
    }
    SEAM(4);
    if (IN(5)) {
        pg8::Gemm g{OG, WBR, 1536, 512, 512, (size_t)512 * 2, (size_t)1024 * 512 * 2}; pg8::StaticOrder S; S.init(T, 1024, G, bx, 3);
        EpiMerge E{GB, MGB};
        pg8::gemm_phase(lds, g, S, E);
    }
    SEAM(5);
    if (IN(6)) {
        pg8::Gemm g{MGB, WOUT, 1024, 1024, 1024, 0, 0}; pg8::StaticOrder S; S.init(T, 1024, G, bx);
        EpiOut E{P.x, P.out, STATS};
        pg8::gemm_phase(lds, g, S, E);
    }
    SEAM(6);
    if (IN(7)) {
        const int tid = opaque_tid(), lane = tid & 63, wave = __builtin_amdgcn_readfirstlane(tid >> 6);
        const int gw = vcu * 8 + wave, NGW = G * 8;
        for (int row = gw; row < T; row += NGW) {
            f32x2 st = (lane < 16) ? *(const f32x2*)(STATS + ((size_t)row * 16 + lane) * 2) : (f32x2){0.f, 0.f};
            float s1 = st.x, s2 = st.y;
#pragma unroll
            for (int o = 1; o < 16; o <<= 1) { s1 += __shfl_xor(s1, o); s2 += __shfl_xor(s2, o); }
            s1 = __shfl(s1, 0); s2 = __shfl(s2, 0);
            const float mean = s1 * (1.f / 1024.f), var = fmaxf(s2 * (1.f / 1024.f) - mean * mean, 0.f), rstd = rsqrtf(var + 1e-5f);
            f32x4* orow = (f32x4*)(P.out + (size_t)row * 1024) + lane;
#pragma unroll
            for (int j = 0; j < 4; ++j) { const f32x4 v = orow[64 * j], gn = *((const f32x4*)P.ln_g + lane + 64 * j), bs = *((const f32x4*)P.ln_b + lane + 64 * j);
                orow[64 * j] = (v - mean) * rstd * gn + bs; }
        }
    }
#undef IN
#undef SEAM
}

extern "C" void kernel_launch(void* const* d_in, const int* in_sizes, int n_in, void* d_out, int out_size, void* d_ws, size_t ws_size, hipStream_t stream) {
    static int grid = 0;
    if (grid == 0) {
        if (n_in != 16 || in_sizes[0] != T * D_MODEL || out_size != T * D_MODEL || ws_size < WS_END) { fprintf(stderr, "kernel_launch: unexpected shapes (n_in %d, in0 %d, out %d, ws %zu)\n", n_in, n_in > 0 ? in_sizes[0] : -1, out_size, ws_size); grid = -1; return; }
        int dev = 0, cus = 0, per_cu = 0;
        (void)hipGetDevice(&dev); (void)hipDeviceGetAttribute(&cus, hipDeviceAttributeMultiprocessorCount, dev);
        if (hipFuncSetAttribute((const void*)fwd_kernel, hipFuncAttributeMaxDynamicSharedMemorySize, LDS_BYTES) != hipSuccess) { fprintf(stderr, "kernel_launch: hipFuncSetAttribute failed\n"); grid = -1; return; }
        if (hipOccupancyMaxActiveBlocksPerMultiprocessor(&per_cu, (const void*)fwd_kernel, 512, LDS_BYTES) != hipSuccess || per_cu < 1) { fprintf(stderr, "kernel_launch: occupancy query gave %d\n", per_cu); per_cu = 1; }
        (void)hipGetLastError();
        grid = cus * per_cu;
    }
    if (grid < 0) return;
    Params p{};
    p.x = (const float*)d_in[0]; p.mem = (const float*)d_in[1]; p.w_in = (const float*)d_in[2]; p.w_mem_kv = (const float*)d_in[3]; p.q_a_gain = (const float*)d_in[4];
    p.w_q_b = (const float*)d_in[5]; p.kv_a_gain = (const float*)d_in[6]; p.w_kv_b = (const float*)d_in[7]; p.w_br[0] = (const float*)d_in[8]; p.w_br[1] = (const float*)d_in[9];
    p.w_br[2] = (const float*)d_in[10]; p.w_mg = (const float*)d_in[11]; p.b_mg = (const float*)d_in[12]; p.w_out = (const float*)d_in[13]; p.ln_g = (const float*)d_in[14]; p.ln_b = (const float*)d_in[15];
    p.out = (float*)d_out; p.ws = (unsigned char*)d_ws; p.ph_lo = 0; p.ph_hi = 8;
    void* args[] = {&p};
    hipError_t e = hipLaunchCooperativeKernel((const void*)fwd_kernel, dim3(grid), dim3(512), args, LDS_BYTES, stream);
    if (e != hipSuccess) fprintf(stderr, "cooperative launch failed: %s (grid %d)\n", hipGetErrorString(e), grid);
}
```
